# Optimizing an MI355X kernel written in HIP

```python
import jax, jax.numpy as jnp
from jax import lax
import numpy as np

D_MODEL = 2048
BATCH = 4
SEQ = 4096
DEPTH = 1

D_MIX = D_MODEL
D_A = D_MIX // 2
CHUNK = 128
A_GROUPS = 8
A_GROUP_W = D_A // A_GROUPS
D_B = D_MIX - D_A
HEAD_DIM = 64
N_Q_HEADS = D_B // HEAD_DIM
N_KV_HEADS = 4
Q_PER_KV = N_Q_HEADS // N_KV_HEADS
D_KV = N_KV_HEADS * HEAD_DIM
WINDOW = 128
BLOCK = WINDOW
ROPE_THETA = 10000.0
NORM_EPS = 1e-5
SPLIT_SIZES = (D_A, D_A, D_A, D_B, D_KV, D_KV, D_B)
D_IN = sum(SPLIT_SIZES)

kernel_name = "hymba_gmlp_swa_sink_adaln"


def rms_norm(x, g):
    xf = x.astype(jnp.float32)
    y = xf * lax.rsqrt(jnp.mean(xf * xf, axis=-1, keepdims=True) + NORM_EPS)
    return (y * g.astype(jnp.float32)).astype(x.dtype)


def layer_norm(x, g, b):
    xf = x.astype(jnp.float32)
    mu = jnp.mean(xf, axis=-1, keepdims=True)
    xc = xf - mu
    var = jnp.mean(xc * xc, axis=-1, keepdims=True)
    y = xc * lax.rsqrt(var + NORM_EPS)
    return (y * g.astype(jnp.float32) + b.astype(jnp.float32)).astype(x.dtype)


def modulate(h, shift, scale):
    return h * (1.0 + scale[:, None, :]) + shift[:, None, :]


def rope_tables(seq, dtype):
    inv_freq = ROPE_THETA ** (-jnp.arange(0, HEAD_DIM, 2, dtype=jnp.float32) / HEAD_DIM)
    ang = jnp.arange(seq, dtype=jnp.float32)[:, None] * inv_freq[None, :]
    return jnp.cos(ang).astype(dtype), jnp.sin(ang).astype(dtype)


def apply_rope(x, cos, sin):
    x1, x2 = jnp.split(x, 2, axis=-1)
    c = cos[None, :, None, :]
    s = sin[None, :, None, :]
    return jnp.concatenate([x1 * c - x2 * s, x2 * c + x1 * s], axis=-1)


def chunked_spatial_gating(u, v, ln_g, ln_b, w_s, b_s):
    bsz, seq, _ = v.shape
    n_chunks = seq // CHUNK
    v = layer_norm(v, ln_g, ln_b)
    vg = v.reshape(bsz, n_chunks, CHUNK, A_GROUPS, A_GROUP_W)
    w = w_s * jnp.tril(jnp.ones((CHUNK, CHUNK), w_s.dtype))[None]
    s = jnp.einsum('gts,bcsgd->bctgd', w, vg) + b_s.T[None, None, :, :, None]
    return u * s.reshape(bsz, seq, D_A)


def sliding_window_sink_attention(q, k, v, sinks):
    bsz, seq = q.shape[0], q.shape[1]
    nb = seq // BLOCK
    qb = q.reshape(bsz, nb, BLOCK, N_KV_HEADS, Q_PER_KV, HEAD_DIM)
    kb = k.reshape(bsz, nb, BLOCK, N_KV_HEADS, HEAD_DIM)
    vb = v.reshape(bsz, nb, BLOCK, N_KV_HEADS, HEAD_DIM)
    pad = ((0, 0), (1, 0), (0, 0), (0, 0), (0, 0))
    k_band = jnp.concatenate([jnp.pad(kb, pad)[:, :-1], kb], axis=2)
    v_band = jnp.concatenate([jnp.pad(vb, pad)[:, :-1], vb], axis=2)
    scale = HEAD_DIM ** -0.5
    scores = jnp.einsum('bnqkgd,bnjkd->bnkgqj', qb, k_band).astype(jnp.float32) * scale
    blk = jnp.arange(nb)[:, None]
    qpos = blk * BLOCK + jnp.arange(BLOCK)[None, :]
    kpos = (blk - 1) * BLOCK + jnp.arange(2 * BLOCK)[None, :]
    rel = qpos[:, :, None] - kpos[:, None, :]
    valid = (rel >= 0) & (rel < WINDOW) & (kpos[:, None, :] >= 0)
    scores = jnp.where(valid[None, :, None, None, :, :], scores, -jnp.inf)
    sink = sinks.astype(jnp.float32).reshape(N_KV_HEADS, Q_PER_KV)[None, None, :, :, None, None]
    m = jnp.maximum(jnp.max(scores, axis=-1, keepdims=True), sink)
    p = jnp.exp(scores - m)
    denom = jnp.sum(p, axis=-1, keepdims=True) + jnp.exp(sink - m)
    probs = (p / denom).astype(v.dtype)
    out = jnp.einsum('bnkgqj,bnjkd->bnqkgd', probs, v_band)
    return out.reshape(bsz, seq, N_Q_HEADS * HEAD_DIM)


def setup_inputs(seed: int = 0) -> dict:
    key = jax.random.key(seed)
    ks = jax.random.split(key, 16)
    f32 = jnp.float32
    ada_std = 0.2 * D_MODEL ** -0.5
    return {
        "x": jax.random.normal(ks[0], (BATCH, SEQ, D_MODEL), f32),
        "c": jax.random.normal(ks[1], (BATCH, D_MODEL), f32),
        "w_ada": jax.random.normal(ks[2], (DEPTH, D_MODEL, 3 * D_MODEL), f32) * ada_std,
        "b_ada": jax.random.normal(ks[3], (DEPTH, 3 * D_MODEL), f32) * 0.02,
        "norm_g": 1.0 + 0.02 * jax.random.normal(ks[4], (DEPTH, D_MODEL), f32),
        "w_in": jax.random.normal(ks[5], (DEPTH, D_MODEL, D_IN), f32) * D_MODEL ** -0.5,
        "ln_v_g": 1.0 + 0.02 * jax.random.normal(ks[6], (DEPTH, D_A), f32),
        "ln_v_b": 0.02 * jax.random.normal(ks[7], (DEPTH, D_A), f32),
        "w_spatial": jax.random.normal(ks[8], (DEPTH, A_GROUPS, CHUNK, CHUNK), f32) * (0.5 * CHUNK ** -0.5),
        "b_spatial": 1.0 + 0.02 * jax.random.normal(ks[9], (DEPTH, A_GROUPS, CHUNK), f32),
        "sinks": 0.5 * jax.random.normal(ks[10], (DEPTH, N_Q_HEADS), f32),
        "w_out": jax.random.normal(ks[11], (DEPTH, D_MIX, D_MODEL), f32) * D_MIX ** -0.5,
        "w_ada_final": jax.random.normal(ks[12], (D_MODEL, 2 * D_MODEL), f32) * ada_std,
        "b_ada_final": jax.random.normal(ks[13], (2 * D_MODEL,), f32) * 0.02,
        "final_norm_g": 1.0 + 0.02 * jax.random.normal(ks[14], (D_MODEL,), f32),
    }


def reference(x, c, w_ada, b_ada, norm_g, w_in, ln_v_g, ln_v_b, w_spatial, b_spatial,
              sinks, w_out, w_ada_final, b_ada_final, final_norm_g):
    bsz, seq, _ = x.shape
    c_act = jax.nn.silu(c)
    cos, sin = rope_tables(seq, x.dtype)
    offs = np.cumsum((0,) + SPLIT_SIZES)[:-1].tolist()[1:]
    for l in range(DEPTH):
        mod = c_act @ w_ada[l] + b_ada[l]
        shift, scale, gate = jnp.split(mod, 3, axis=-1)
        h = modulate(rms_norm(x, norm_g[l]), shift, scale)
        proj = h @ w_in[l]
        u_a, v_a, z_a, q, k, v, z_b = jnp.split(proj, offs, axis=-1)
        y_a = chunked_spatial_gating(u_a, v_a, ln_v_g[l], ln_v_b[l], w_spatial[l], b_spatial[l])
        q = apply_rope(q.reshape(bsz, seq, N_Q_HEADS, HEAD_DIM), cos, sin)
        k = apply_rope(k.reshape(bsz, seq, N_KV_HEADS, HEAD_DIM), cos, sin)
        v = v.reshape(bsz, seq, N_KV_HEADS, HEAD_DIM)
        y_b = sliding_window_sink_attention(q, k, v, sinks[l])
        y = jnp.concatenate([y_a * jax.nn.silu(z_a), y_b * jax.nn.silu(z_b)], axis=-1)
        x = x + gate[:, None, :] * (y @ w_out[l])
    mod_f = c_act @ w_ada_final + b_ada_final
    shift_f, scale_f = jnp.split(mod_f, 2, axis=-1)
    return modulate(rms_norm(x, final_norm_g), shift_f, scale_f)
```

```cpp
#include <hip/hip_runtime.h>
#include <cstdio>
#include <cstdint>

typedef unsigned short bf16_t;
typedef short bf16x8 __attribute__((ext_vector_type(8)));
typedef float f32x4 __attribute__((ext_vector_type(4)));

constexpr int D_MODEL = 2048, BATCH = 4, SEQ = 4096, M = BATCH * SEQ;
constexpr int D_A = 1024, CHUNK = 128, A_GROUPS = 8, D_B = 1024, HEAD_DIM = 64, NQH = 16, NKVH = 4, D_KV = 256, WINDOW = 128;
constexpr int D_IN = 5632;
constexpr float NORM_EPS = 1e-5f;
constexpr float LOG2E = 1.4426950408889634f;
constexpr float QSCALE = 0.125f * LOG2E;

constexpr size_t MiB = 1u << 20;
constexpr size_t WS_CTL = 0, WS_MOD = 1 * MiB, WS_ROPE = 2 * MiB, WS_WS = 3 * MiB, WS_VST = 4 * MiB, WS_FST = 6 * MiB, WS_WIN = 8 * MiB, WS_WOUT = 30 * MiB,
                 WS_H = 40 * MiB, WS_U = 104 * MiB, WS_V = 136 * MiB, WS_ZA = 168 * MiB, WS_Q = 200 * MiB, WS_K = 232 * MiB, WS_VB = 240 * MiB, WS_ZB = 248 * MiB,
                 WS_Y = 280 * MiB, WS_QKRAW = 344 * MiB, WS_END = 424 * MiB;

__device__ __forceinline__ unsigned f2bf(float f) { unsigned u = __builtin_bit_cast(unsigned, f); return (u + 0x7fffu + ((u >> 16) & 1u)) >> 16; }
__device__ __forceinline__ float bf2f(unsigned short h) { return __builtin_bit_cast(float, (unsigned)h << 16); }
__device__ __forceinline__ float siluf(float v) { return v / (1.f + __expf(-v)); }

__device__ const double INV_FREQ[32] = {
1.0, 0.7498942093324559, 0.5623413251903491, 0.4216965034285822, 0.31622776601683794, 0.23713737056616552, 0.1778279410038923, 0.1333521432163324,
0.1, 0.07498942093324558, 0.05623413251903491, 0.04216965034285822, 0.03162277660168379, 0.023713737056616554, 0.01778279410038923, 0.01333521432163324,
0.01, 0.007498942093324559, 0.005623413251903491, 0.004216965034285823, 0.0031622776601683794, 0.0023713737056616554, 0.0017782794100389228, 0.0013335214321633241,
0.001, 0.0007498942093324559, 0.0005623413251903491, 0.0004216965034285822, 0.00031622776601683794, 0.00023713737056616554, 0.00017782794100389227, 0.0001333521432163324};

__global__ void __launch_bounds__(64) k_mod(const float* c, const float* w_ada, const float* b_ada, const float* w_adaf, const float* b_adaf, float* mod, float* modf) {
    __shared__ float ca[4][2048];
    for (int i = threadIdx.x; i < 4 * 2048; i += 64) ca[i / 2048][i % 2048] = siluf(c[i]);
    __syncthreads();
    int n = blockIdx.x * 64 + threadIdx.x;
    const float* W; int N; const float* bias; float* out; int col;
    if (n < 6144) { W = w_ada; N = 6144; bias = b_ada; out = mod; col = n; } else { W = w_adaf; N = 4096; bias = b_adaf; out = modf; col = n - 6144; }
    float a0 = 0.f, a1 = 0.f, a2 = 0.f, a3 = 0.f;
    for (int k = 0; k < 2048; ++k) { float w = W[(size_t)k * N + col]; a0 += ca[0][k] * w; a1 += ca[1][k] * w; a2 += ca[2][k] * w; a3 += ca[3][k] * w; }
    float bb = bias[col];
    out[0 * N + col] = a0 + bb; out[1 * N + col] = a1 + bb; out[2 * N + col] = a2 + bb; out[3 * N + col] = a3 + bb;
}
__global__ void k_wT(const float* W, int K, int N, bf16_t* WT) {
    size_t i = (size_t)blockIdx.x * 256 + threadIdx.x; if (i >= (size_t)K * N) return;
    int k = (int)(i / N), n = (int)(i % N);
    WT[(size_t)n * K + k] = (bf16_t)f2bf(W[i]);
}
__global__ void k_rope(float2* tab) {
    int i = blockIdx.x * 256 + threadIdx.x; if (i >= SEQ * 32) return;
    int t = i / 32, f = i % 32;
    double ang = (double)t * INV_FREQ[f];
    double rev = ang * 0.15915494309189535; double fr = rev - floor(rev);
    float frf = (float)fr;
    tab[i] = make_float2(__builtin_amdgcn_cosf(frf), __builtin_amdgcn_sinf(frf));
}
__global__ void k_ws(const float* w_sp, bf16_t* ws) {
    int i = blockIdx.x * 256 + threadIdx.x; if (i >= 8 * 128 * 128) return;
    int t = (i / 128) % 128, tp = i % 128;
    ws[i] = tp <= t ? (bf16_t)f2bf(w_sp[i]) : (bf16_t)0;
}
__global__ void __launch_bounds__(256) k_h(const float* x, const float* g, const float* mod, bf16_t* H) {
    int row = blockIdx.x * 4 + (threadIdx.x >> 6), lane = threadIdx.x & 63, b = row / SEQ;
    const float* xr = x + (size_t)row * D_MODEL;
    float v[32]; float s = 0.f;
#pragma unroll
    for (int j = 0; j < 32; ++j) { v[j] = xr[j * 64 + lane]; s += v[j] * v[j]; }
#pragma unroll
    for (int o = 1; o < 64; o <<= 1) s += __shfl_xor(s, o);
    float rstd = 1.f / sqrtf(s * (1.f / D_MODEL) + NORM_EPS);
    const float* shift = mod + (size_t)b * 6144; const float* scale = shift + 2048;
#pragma unroll
    for (int j = 0; j < 32; ++j) { int c = j * 64 + lane; float y = v[j] * rstd * g[c]; y = y * (1.f + scale[c]) + shift[c]; H[(size_t)row * D_MODEL + c] = (bf16_t)f2bf(y); }
}
struct EpiIn { bf16_t *U, *V, *ZA, *VB, *ZB; float* QKRAW;
    __device__ void operator()(int row, int col, float v) const {
        if (col < 1024) U[(size_t)row * 1024 + col] = (bf16_t)f2bf(v);
        else if (col < 2048) V[(size_t)row * 1024 + col - 1024] = (bf16_t)f2bf(v);
        else if (col < 3072) ZA[(size_t)row * 1024 + col - 2048] = (bf16_t)f2bf(siluf(v));
        else if (col < 4352) QKRAW[(size_t)row * 1280 + col - 3072] = v;
        else if (col < 4608) VB[(size_t)row * 256 + col - 4352] = (bf16_t)f2bf(v);
        else ZB[(size_t)row * 1024 + col - 4608] = (bf16_t)f2bf(siluf(v));
    } };
struct EpiOut { const float* x; const float* mod; float* out;
    __device__ void operator()(int row, int col, float v) const {
        int b = row / SEQ; float gate = mod[(size_t)b * 6144 + 4096 + col];
        out[(size_t)row * D_MODEL + col] = x[(size_t)row * D_MODEL + col] + gate * v;
    } };
template <class Epi> __global__ void __launch_bounds__(256) k_gemm(const bf16_t* A, const bf16_t* Bt, int Mr, int N, int K, Epi E) {
    int wid = threadIdx.x >> 6, lane = threadIdx.x & 63;
    int m0 = blockIdx.y * 64 + (wid >> 1) * 32, n0 = blockIdx.x * 64 + (wid & 1) * 32;
    int r = lane & 15, q = lane >> 4;
    f32x4 acc[2][2];
#pragma unroll
    for (int i = 0; i < 2; ++i)
#pragma unroll
        for (int j = 0; j < 2; ++j) acc[i][j] = (f32x4){0.f, 0.f, 0.f, 0.f};
    for (int k0 = 0; k0 < K; k0 += 32) {
        bf16x8 a[2], b[2];
#pragma unroll
        for (int i = 0; i < 2; ++i) a[i] = *(const bf16x8*)(A + (size_t)(m0 + i * 16 + r) * K + k0 + q * 8);
#pragma unroll
        for (int j = 0; j < 2; ++j) b[j] = *(const bf16x8*)(Bt + (size_t)(n0 + j * 16 + r) * K + k0 + q * 8);
#pragma unroll
        for (int i = 0; i < 2; ++i)
#pragma unroll
            for (int j = 0; j < 2; ++j) acc[i][j] = __builtin_amdgcn_mfma_f32_16x16x32_bf16(a[i], b[j], acc[i][j], 0, 0, 0);
    }
#pragma unroll
    for (int i = 0; i < 2; ++i)
#pragma unroll
        for (int j = 0; j < 2; ++j)
#pragma unroll
            for (int e = 0; e < 4; ++e) E(m0 + i * 16 + q * 4 + e, n0 + j * 16 + r, acc[i][j][e]);
}
__global__ void k_ropeqk(const float* raw, const float2* tab, bf16_t* Q, bf16_t* Kb) {
    size_t i = (size_t)blockIdx.x * 256 + threadIdx.x; if (i >= (size_t)M * 20 * 32) return;
    int f = (int)(i % 32), head = (int)((i / 32) % 20), row = (int)(i / 640), t = row % SEQ;
    float x1 = raw[(size_t)row * 1280 + head * 64 + f], x2 = raw[(size_t)row * 1280 + head * 64 + f + 32];
    float2 cs = tab[t * 32 + f];
    float o1 = x1 * cs.x - x2 * cs.y, o2 = x2 * cs.x + x1 * cs.y;
    if (head < 16) { Q[(size_t)row * 1024 + head * 64 + f] = (bf16_t)f2bf(o1 * QSCALE); Q[(size_t)row * 1024 + head * 64 + f + 32] = (bf16_t)f2bf(o2 * QSCALE); }
    else { Kb[(size_t)row * 256 + (head - 16) * 64 + f] = (bf16_t)f2bf(o1); Kb[(size_t)row * 256 + (head - 16) * 64 + f + 32] = (bf16_t)f2bf(o2); }
}
__global__ void k_vstat(const bf16_t* V, float2* vst) {
    int row = blockIdx.x * 256 + threadIdx.x; if (row >= M) return;
    float s = 0.f, q = 0.f;
    for (int c = 0; c < 1024; ++c) { float v = bf2f(V[(size_t)row * 1024 + c]); s += v; q += v * v; }
    vst[(size_t)row * 16] = make_float2(s, q);
    for (int j = 1; j < 16; ++j) vst[(size_t)row * 16 + j] = make_float2(0.f, 0.f);
}
__global__ void __launch_bounds__(128) k_gate(const bf16_t* U, const bf16_t* V, const bf16_t* ZA, const float2* vst, const float* lg, const float* lb, const bf16_t* Ws, const float* bs, bf16_t* Y) {
    __shared__ unsigned short tile[128][128];
    __shared__ float2 st[128];
    int ck = blockIdx.x, g = blockIdx.y, c = threadIdx.x, cg = g * 128 + c;
    {
        int row = ck * 128 + c; float s = 0.f, q = 0.f;
        for (int j = 0; j < 16; ++j) { float2 p = vst[(size_t)row * 16 + j]; s += p.x; q += p.y; }
        float mean = s * (1.f / 1024.f), var = q * (1.f / 1024.f) - mean * mean;
        st[c] = make_float2(mean, 1.f / sqrtf(var + NORM_EPS));
    }
    __syncthreads();
    float gg = lg[cg], bb = lb[cg];
    for (int tp = 0; tp < 128; ++tp) { float v = bf2f(V[(size_t)(ck * 128 + tp) * 1024 + cg]); float y = (v - st[tp].x) * st[tp].y * gg + bb; tile[tp][c] = (unsigned short)f2bf(y); }
    __syncthreads();
    for (int t = 0; t < 128; ++t) {
        float s = 0.f; const bf16_t* wr = Ws + ((size_t)g * 128 + t) * 128;
        for (int tp = 0; tp <= t; ++tp) s += bf2f(wr[tp]) * bf2f(tile[tp][c]);
        s += bs[g * 128 + t];
        size_t row = (size_t)ck * 128 + t;
        float u = bf2f(U[row * 1024 + cg]), z = bf2f(ZA[row * 1024 + cg]);
        Y[row * 2048 + cg] = (bf16_t)f2bf(u * s * z);
    }
}
__global__ void __launch_bounds__(64) k_attn(const bf16_t* Q, const bf16_t* Kb, const bf16_t* Vb, const bf16_t* ZB, const float* sinks, bf16_t* Y) {
    __shared__ float qs[64]; __shared__ float ps[128];
    int row = blockIdx.x, h = blockIdx.y, kvh = h / 4, lane = threadIdx.x, t = row % SEQ, b = row / SEQ;
    qs[lane] = bf2f(Q[(size_t)row * 1024 + h * 64 + lane]);
    __syncthreads();
    float sc[2]; float mx = sinks[h] * LOG2E;
#pragma unroll
    for (int p = 0; p < 2; ++p) {
        int j = lane + 64 * p, tk = t - 127 + j; float s = -INFINITY;
        if (tk >= 0) { const bf16_t* kr = Kb + ((size_t)b * SEQ + tk) * 256 + kvh * 64; s = 0.f; for (int d = 0; d < 64; ++d) s += qs[d] * bf2f(kr[d]); }
        sc[p] = s; mx = fmaxf(mx, s);
    }
#pragma unroll
    for (int o = 1; o < 64; o <<= 1) mx = fmaxf(mx, __shfl_xor(mx, o));
    float sum = 0.f;
#pragma unroll
    for (int p = 0; p < 2; ++p) { float e = exp2f(sc[p] - mx); e = bf2f((unsigned short)f2bf(e)); ps[lane + 64 * p] = e; sum += e; }
    sum = 0.f;
#pragma unroll
    for (int p = 0; p < 2; ++p) sum += exp2f(sc[p] - mx);
#pragma unroll
    for (int o = 1; o < 64; o <<= 1) sum += __shfl_xor(sum, o);
    sum += exp2f(sinks[h] * LOG2E - mx);
    __syncthreads();
    float o = 0.f;
    for (int j = 0; j < 128; ++j) { int tk = t - 127 + j; if (tk < 0) continue; o += ps[j] * bf2f(Vb[((size_t)b * SEQ + tk) * 256 + kvh * 64 + lane]); }
    float z = bf2f(ZB[(size_t)row * 1024 + h * 64 + lane]);
    Y[(size_t)row * 2048 + 1024 + h * 64 + lane] = (bf16_t)f2bf(o / sum * z);
}
__global__ void __launch_bounds__(256) k_final(float* out, const float* gf, const float* modf) {
    int row = blockIdx.x * 4 + (threadIdx.x >> 6), lane = threadIdx.x & 63, b = row / SEQ;
    float* xr = out + (size_t)row * D_MODEL;
    float v[32]; float s = 0.f;
#pragma unroll
    for (int j = 0; j < 32; ++j) { v[j] = xr[j * 64 + lane]; s += v[j] * v[j]; }
#pragma unroll
    for (int o = 1; o < 64; o <<= 1) s += __shfl_xor(s, o);
    float rstd = 1.f / sqrtf(s * (1.f / D_MODEL) + NORM_EPS);
    const float* shift = modf + (size_t)b * 4096; const float* scale = shift + 2048;
#pragma unroll
    for (int j = 0; j < 32; ++j) { int c = j * 64 + lane; float y = v[j] * rstd * gf[c]; xr[c] = y * (1.f + scale[c]) + shift[c]; }
}

extern "C" void kernel_launch(void* const* d_in, const int* in_sizes, int n_in, void* d_out, int out_size, void* d_ws, size_t ws_size, hipStream_t stream) {
    if (ws_size < WS_END) { fprintf(stderr, "ws too small: %zu < %zu\n", ws_size, (size_t)WS_END); return; }
    const float* x = (const float*)d_in[0]; const float* c = (const float*)d_in[1]; const float* w_ada = (const float*)d_in[2]; const float* b_ada = (const float*)d_in[3];
    const float* norm_g = (const float*)d_in[4]; const float* w_in = (const float*)d_in[5]; const float* ln_g = (const float*)d_in[6]; const float* ln_b = (const float*)d_in[7];
    const float* w_sp = (const float*)d_in[8]; const float* b_sp = (const float*)d_in[9]; const float* sinks = (const float*)d_in[10]; const float* w_out = (const float*)d_in[11];
    const float* w_adaf = (const float*)d_in[12]; const float* b_adaf = (const float*)d_in[13]; const float* gf = (const float*)d_in[14];
    unsigned char* ws = (unsigned char*)d_ws; float* out = (float*)d_out;
    float* mod = (float*)(ws + WS_MOD); float* modf = mod + 4 * 6144; float2* rope = (float2*)(ws + WS_ROPE); bf16_t* Wsb = (bf16_t*)(ws + WS_WS); float2* vst = (float2*)(ws + WS_VST);
    bf16_t* WinT = (bf16_t*)(ws + WS_WIN); bf16_t* WoutT = (bf16_t*)(ws + WS_WOUT); bf16_t* H = (bf16_t*)(ws + WS_H);
    bf16_t* U = (bf16_t*)(ws + WS_U); bf16_t* V = (bf16_t*)(ws + WS_V); bf16_t* ZA = (bf16_t*)(ws + WS_ZA); bf16_t* Q = (bf16_t*)(ws + WS_Q); bf16_t* Kb = (bf16_t*)(ws + WS_K);
    bf16_t* VB = (bf16_t*)(ws + WS_VB); bf16_t* ZB = (bf16_t*)(ws + WS_ZB); bf16_t* Y = (bf16_t*)(ws + WS_Y); float* QKRAW = (float*)(ws + WS_QKRAW);
    k_mod<<<160, 64, 0, stream>>>(c, w_ada, b_ada, w_adaf, b_adaf, mod, modf);
    k_wT<<<(2048 * 5632 + 255) / 256, 256, 0, stream>>>(w_in, 2048, 5632, WinT);
    k_wT<<<(2048 * 2048 + 255) / 256, 256, 0, stream>>>(w_out, 2048, 2048, WoutT);
    k_rope<<<(SEQ * 32 + 255) / 256, 256, 0, stream>>>(rope);
    k_ws<<<(8 * 128 * 128 + 255) / 256, 256, 0, stream>>>(w_sp, Wsb);
    k_h<<<M / 4, 256, 0, stream>>>(x, norm_g, mod, H);
    k_gemm<EpiIn><<<dim3(D_IN / 64, M / 64), 256, 0, stream>>>(H, WinT, M, D_IN, 2048, EpiIn{U, V, ZA, VB, ZB, QKRAW});
    k_ropeqk<<<(int)(((size_t)M * 640 + 255) / 256), 256, 0, stream>>>(QKRAW, rope, Q, Kb);
    k_vstat<<<M / 256, 256, 0, stream>>>(V, vst);
    k_gate<<<dim3(M / 128, 8), 128, 0, stream>>>(U, V, ZA, vst, ln_g, ln_b, Wsb, b_sp, Y);
    k_attn<<<dim3(M, 16), 64, 0, stream>>>(Q, Kb, VB, ZB, sinks, Y);
    k_gemm<EpiOut><<<dim3(2048 / 64, M / 64), 256, 0, stream>>>(Y, WoutT, M, 2048, 2048, EpiOut{x, mod, out});
    k_final<<<M / 4, 256, 0, stream>>>(out, gf, modf);
}
```

```cpp
#include <hip/hip_runtime.h>
#include <cstdio>
#include <cstdint>

#ifndef MK_ONE_LAUNCH
#define MK_ONE_LAUNCH 0
#endif
#ifndef NAIVE_MASK
#define NAIVE_MASK 0
#endif

#define GAS __attribute__((address_space(1)))
#define LAS __attribute__((address_space(3)))
typedef unsigned short bf16_t;
typedef short bf16x8 __attribute__((ext_vector_type(8)));
typedef short s16x4 __attribute__((ext_vector_type(4)));
typedef float f32x4 __attribute__((ext_vector_type(4)));
typedef float f32x2 __attribute__((ext_vector_type(2)));
typedef float f32x16 __attribute__((ext_vector_type(16)));
typedef unsigned u32x4 __attribute__((ext_vector_type(4)));
typedef unsigned u32x2 __attribute__((ext_vector_type(2)));

constexpr int D_MODEL = 2048, BATCH = 4, SEQ = 4096, M = BATCH * SEQ;
constexpr int D_IN = 5632;
constexpr float NORM_EPS = 1e-5f;
constexpr float LOG2E = 1.4426950408889634f;
constexpr float QSCALE = 0.125f * LOG2E;
constexpr int NWAVES = 8, NTHREADS = 512;

constexpr size_t MiB = 1u << 20;
constexpr size_t WS_CTL = 0, CTL_ZERO_BYTES = 64 * 1024, WS_MOD = 1 * MiB, WS_ROPE = 2 * MiB, WS_WS = 3 * MiB, WS_VST = 4 * MiB, WS_FST = 6 * MiB, WS_WIN = 8 * MiB, WS_WOUT = 30 * MiB,
                 WS_H = 40 * MiB, WS_U = 104 * MiB, WS_V = 136 * MiB, WS_ZA = 168 * MiB, WS_Q = 200 * MiB, WS_K = 232 * MiB, WS_VB = 240 * MiB, WS_ZB = 248 * MiB,
                 WS_Y = 280 * MiB, WS_QKRAW = 344 * MiB, WS_END = 424 * MiB;
constexpr int CW_BAR = 1024;

__device__ __forceinline__ unsigned f2bf(float f) { unsigned u = __builtin_bit_cast(unsigned, f); return (u + 0x7fffu + ((u >> 16) & 1u)) >> 16; }
__device__ __forceinline__ unsigned pk2(float lo, float hi) { return f2bf(lo) | (f2bf(hi) << 16); }
__device__ __forceinline__ float bf2f(unsigned short h) { return __builtin_bit_cast(float, (unsigned)h << 16); }
__device__ __forceinline__ float bflo(unsigned w) { return __builtin_bit_cast(float, w << 16); }
__device__ __forceinline__ float bfhi(unsigned w) { return __builtin_bit_cast(float, w & 0xffff0000u); }
__device__ __forceinline__ float siluf(float v) { return v / (1.f + __expf(-v)); }
__device__ __forceinline__ float silu_fast(float v) { return v * __builtin_amdgcn_rcpf(1.f + __builtin_amdgcn_exp2f(-v * LOG2E)); }
__device__ __forceinline__ unsigned cvt_pk_bf16(float lo, float hi) { unsigned r; asm volatile("v_cvt_pk_bf16_f32 %0, %1, %2" : "=v"(r) : "v"(lo), "v"(hi)); return r; }

__device__ const double INV_FREQ[32] = {
1.0, 0.7498942093324559, 0.5623413251903491, 0.4216965034285822, 0.31622776601683794, 0.23713737056616552, 0.1778279410038923, 0.1333521432163324,
0.1, 0.07498942093324558, 0.05623413251903491, 0.04216965034285822, 0.03162277660168379, 0.023713737056616554, 0.01778279410038923, 0.01333521432163324,
0.01, 0.007498942093324559, 0.005623413251903491, 0.004216965034285823, 0.0031622776601683794, 0.0023713737056616554, 0.0017782794100389228, 0.0013335214321633241,
0.001, 0.0007498942093324559, 0.0005623413251903491, 0.0004216965034285822, 0.00031622776601683794, 0.00023713737056616554, 0.00017782794100389227, 0.0001333521432163324};
__device__ __forceinline__ float2 rope_entry(int t, int f) {
    double ang = (double)t * INV_FREQ[f]; double rev = ang * 0.15915494309189535; double fr = rev - floor(rev); float frf = (float)fr;
    return make_float2(__builtin_amdgcn_cosf(frf), __builtin_amdgcn_sinf(frf));
}

#if NAIVE_MASK != 0
namespace nv {
__global__ void __launch_bounds__(64) k_mod(const float* c, const float* w_ada, const float* b_ada, const float* w_adaf, const float* b_adaf, float* mod, float* modf) {
    __shared__ float ca[4][2048];
    for (int i = threadIdx.x; i < 4 * 2048; i += 64) ca[i / 2048][i % 2048] = siluf(c[i]);
    __syncthreads();
    int n = blockIdx.x * 64 + threadIdx.x;
    const float* W; int N; const float* bias; float* out; int col;
    if (n < 6144) { W = w_ada; N = 6144; bias = b_ada; out = mod; col = n; } else { W = w_adaf; N = 4096; bias = b_adaf; out = modf; col = n - 6144; }
    float a0 = 0.f, a1 = 0.f, a2 = 0.f, a3 = 0.f;
    for (int k = 0; k < 2048; ++k) { float w = W[(size_t)k * N + col]; a0 += ca[0][k] * w; a1 += ca[1][k] * w; a2 += ca[2][k] * w; a3 += ca[3][k] * w; }
    float bb = bias[col];
    out[0 * N + col] = a0 + bb; out[1 * N + col] = a1 + bb; out[2 * N + col] = a2 + bb; out[3 * N + col] = a3 + bb;
}
__global__ void k_wT(const float* W, int K, int N, bf16_t* WT) {
    size_t i = (size_t)blockIdx.x * 256 + threadIdx.x; if (i >= (size_t)K * N) return;
    int k = (int)(i / N), n = (int)(i % N);
    WT[(size_t)n * K + k] = (bf16_t)f2bf(W[i]);
}
__global__ void k_rope(float2* tab) { int i = blockIdx.x * 256 + threadIdx.x; if (i >= SEQ * 32) return; tab[i] = rope_entry(i / 32, i % 32); }
__global__ void k_ws(const float* w_sp, bf16_t* ws) {
    int i = blockIdx.x * 256 + threadIdx.x; if (i >= 8 * 128 * 128) return;
    int t = (i / 128) % 128, tp = i % 128;
    ws[i] = tp <= t ? (bf16_t)f2bf(w_sp[i]) : (bf16_t)0;
}
__global__ void __launch_bounds__(256) k_h(const float* x, const float* g, const float* mod, bf16_t* H) {
    int row = blockIdx.x * 4 + (threadIdx.x >> 6), lane = threadIdx.x & 63, b = row / SEQ;
    const float* xr = x + (size_t)row * D_MODEL;
    float v[32]; float s = 0.f;
#pragma unroll
    for (int j = 0; j < 32; ++j) { v[j] = xr[j * 64 + lane]; s += v[j] * v[j]; }
#pragma unroll
    for (int o = 1; o < 64; o <<= 1) s += __shfl_xor(s, o);
    float rstd = 1.f / sqrtf(s * (1.f / D_MODEL) + NORM_EPS);
    const float* shift = mod + (size_t)b * 6144; const float* scale = shift + 2048;
#pragma unroll
    for (int j = 0; j < 32; ++j) { int c = j * 64 + lane; float y = v[j] * rstd * g[c]; y = y * (1.f + scale[c]) + shift[c]; H[(size_t)row * D_MODEL + c] = (bf16_t)f2bf(y); }
}
struct EpiIn { bf16_t *U, *V, *ZA, *VB, *ZB; float* QKRAW;
    __device__ void operator()(int row, int col, float v) const {
        if (col < 1024) U[(size_t)row * 1024 + col] = (bf16_t)f2bf(v);
        else if (col < 2048) V[(size_t)row * 1024 + col - 1024] = (bf16_t)f2bf(v);
        else if (col < 3072) ZA[(size_t)row * 1024 + col - 2048] = (bf16_t)f2bf(siluf(v));
        else if (col < 4352) QKRAW[(size_t)row * 1280 + col - 3072] = v;
        else if (col < 4608) VB[(size_t)row * 256 + col - 4352] = (bf16_t)f2bf(v);
        else ZB[(size_t)row * 1024 + col - 4608] = (bf16_t)f2bf(siluf(v));
    } };
struct EpiOut { const float* x; const float* mod; float* out;
    __device__ void operator()(int row, int col, float v) const {
        int b = row / SEQ; float gate = mod[(size_t)b * 6144 + 4096 + col];
        out[(size_t)row * D_MODEL + col] = x[(size_t)row * D_MODEL + col] + gate * v;
    } };
template <class Epi> __global__ void __launch_bounds__(256) k_gemm(const bf16_t* A, const bf16_t* Bt, int Mr, int N, int K, Epi E) {
    int wid = threadIdx.x >> 6, lane = threadIdx.x & 63;
    int m0 = blockIdx.y * 64 + (wid >> 1) * 32, n0 = blockIdx.x * 64 + (wid & 1) * 32;
    int r = lane & 15, q = lane >> 4;
    f32x4 acc[2][2];
#pragma unroll
    for (int i = 0; i < 2; ++i)
#pragma unroll
        for (int j = 0; j < 2; ++j) acc[i][j] = (f32x4){0.f, 0.f, 0.f, 0.f};
    for (int k0 = 0; k0 < K; k0 += 32) {
        bf16x8 a[2], b[2];
#pragma unroll
        for (int i = 0; i < 2; ++i) a[i] = *(const bf16x8*)(A + (size_t)(m0 + i * 16 + r) * K + k0 + q * 8);
#pragma unroll
        for (int j = 0; j < 2; ++j) b[j] = *(const bf16x8*)(Bt + (size_t)(n0 + j * 16 + r) * K + k0 + q * 8);
#pragma unroll
        for (int i = 0; i < 2; ++i)
#pragma unroll
            for (int j = 0; j < 2; ++j) acc[i][j] = __builtin_amdgcn_mfma_f32_16x16x32_bf16(a[i], b[j], acc[i][j], 0, 0, 0);
    }
#pragma unroll
    for (int i = 0; i < 2; ++i)
#pragma unroll
        for (int j = 0; j < 2; ++j)
#pragma unroll
            for (int e = 0; e < 4; ++e) E(m0 + i * 16 + q * 4 + e, n0 + j * 16 + r, acc[i][j][e]);
}
__global__ void k_ropeqk(const float* raw, const float2* tab, bf16_t* Q, bf16_t* Kb) {
    size_t i = (size_t)blockIdx.x * 256 + threadIdx.x; if (i >= (size_t)M * 20 * 32) return;
    int f = (int)(i % 32), head = (int)((i / 32) % 20), row = (int)(i / 640), t = row % SEQ;
    float x1 = raw[(size_t)row * 1280 + head * 64 + f], x2 = raw[(size_t)row * 1280 + head * 64 + f + 32];
    float2 cs = tab[t * 32 + f];
    float o1 = x1 * cs.x - x2 * cs.y, o2 = x2 * cs.x + x1 * cs.y;
    if (head < 16) { Q[(size_t)row * 1024 + head * 64 + f] = (bf16_t)f2bf(o1 * QSCALE); Q[(size_t)row * 1024 + head * 64 + f + 32] = (bf16_t)f2bf(o2 * QSCALE); }
    else { Kb[(size_t)row * 256 + (head - 16) * 64 + f] = (bf16_t)f2bf(o1); Kb[(size_t)row * 256 + (head - 16) * 64 + f + 32] = (bf16_t)f2bf(o2); }
}
__global__ void k_vstat(const bf16_t* V, float2* vst) {
    int row = blockIdx.x * 256 + threadIdx.x; if (row >= M) return;
    float s = 0.f, q = 0.f;
    for (int c = 0; c < 1024; ++c) { float v = bf2f(V[(size_t)row * 1024 + c]); s += v; q += v * v; }
    vst[(size_t)row * 16] = make_float2(s, q);
    for (int j = 1; j < 16; ++j) vst[(size_t)row * 16 + j] = make_float2(0.f, 0.f);
}
__global__ void __launch_bounds__(128) k_gate(const bf16_t* U, const bf16_t* V, const bf16_t* ZA, const float2* vst, const float* lg, const float* lb, const bf16_t* Ws, const float* bs, bf16_t* Y) {
    __shared__ unsigned short tile[128][128];
    __shared__ float2 st[128];
    int ck = blockIdx.x, g = blockIdx.y, c = threadIdx.x, cg = g * 128 + c;
    {
        int row = ck * 128 + c; float s = 0.f, q = 0.f;
        for (int j = 0; j < 16; ++j) { float2 p = vst[(size_t)row * 16 + j]; s += p.x; q += p.y; }
        float mean = s * (1.f / 1024.f), var = q * (1.f / 1024.f) - mean * mean;
        st[c] = make_float2(mean, 1.f / sqrtf(var + NORM_EPS));
    }
    __syncthreads();
    float gg = lg[cg], bb = lb[cg];
    for (int tp = 0; tp < 128; ++tp) { float v = bf2f(V[(size_t)(ck * 128 + tp) * 1024 + cg]); float y = (v - st[tp].x) * st[tp].y * gg + bb; tile[tp][c] = (unsigned short)f2bf(y); }
    __syncthreads();
    for (int t = 0; t < 128; ++t) {
        float s = 0.f; const bf16_t* wr = Ws + ((size_t)g * 128 + t) * 128;
        for (int tp = 0; tp <= t; ++tp) s += bf2f(wr[tp]) * bf2f(tile[tp][c]);
        s += bs[g * 128 + t];
        size_t row = (size_t)ck * 128 + t;
        float u = bf2f(U[row * 1024 + cg]), z = bf2f(ZA[row * 1024 + cg]);
        Y[row * 2048 + cg] = (bf16_t)f2bf(u * s * z);
    }
}
__global__ void __launch_bounds__(64) k_attn(const bf16_t* Q, const bf16_t* Kb, const bf16_t* Vb, const bf16_t* ZB, const float* sinks, bf16_t* Y) {
    __shared__ float qs[64]; __shared__ float ps[128];
    int row = blockIdx.x, h = blockIdx.y, kvh = h / 4, lane = threadIdx.x, t = row % SEQ, b = row / SEQ;
    qs[lane] = bf2f(Q[(size_t)row * 1024 + h * 64 + lane]);
    __syncthreads();
    float sc[2]; float mx = sinks[h] * LOG2E;
#pragma unroll
    for (int p = 0; p < 2; ++p) {
        int j = lane + 64 * p, tk = t - 127 + j; float s = -INFINITY;
        if (tk >= 0) { const bf16_t* kr = Kb + ((size_t)b * SEQ + tk) * 256 + kvh * 64; s = 0.f; for (int d = 0; d < 64; ++d) s += qs[d] * bf2f(kr[d]); }
        sc[p] = s; mx = fmaxf(mx, s);
    }
#pragma unroll
    for (int o = 1; o < 64; o <<= 1) mx = fmaxf(mx, __shfl_xor(mx, o));
    float sum = 0.f;
#pragma unroll
    for (int p = 0; p < 2; ++p) { float e = exp2f(sc[p] - mx); ps[lane + 64 * p] = bf2f((unsigned short)f2bf(e)); sum += e; }
#pragma unroll
    for (int o = 1; o < 64; o <<= 1) sum += __shfl_xor(sum, o);
    sum += exp2f(sinks[h] * LOG2E - mx);
    __syncthreads();
    float o = 0.f;
    for (int j = 0; j < 128; ++j) { int tk = t - 127 + j; if (tk < 0) continue; o += ps[j] * bf2f(Vb[((size_t)b * SEQ + tk) * 256 + kvh * 64 + lane]); }
    float z = bf2f(ZB[(size_t)row * 1024 + h * 64 + lane]);
    Y[(size_t)row * 2048 + 1024 + h * 64 + lane] = (bf16_t)f2bf(o / sum * z);
}
__global__ void __launch_bounds__(256) k_final(float* out, const float* gf, const float* modf) {
    int row = blockIdx.x * 4 + (threadIdx.x >> 6), lane = threadIdx.x & 63, b = row / SEQ;
    float* xr = out + (size_t)row * D_MODEL;
    float v[32]; float s = 0.f;
#pragma unroll
    for (int j = 0; j < 32; ++j) { v[j] = xr[j * 64 + lane]; s += v[j] * v[j]; }
#pragma unroll
    for (int o = 1; o < 64; o <<= 1) s += __shfl_xor(s, o);
    float rstd = 1.f / sqrtf(s * (1.f / D_MODEL) + NORM_EPS);
    const float* shift = modf + (size_t)b * 4096; const float* scale = shift + 2048;
#pragma unroll
    for (int j = 0; j < 32; ++j) { int c = j * 64 + lane; float y = v[j] * rstd * gf[c]; xr[c] = y * (1.f + scale[c]) + shift[c]; }
}
}
#endif

namespace pg8 {
constexpr int BM = 256, BK = 64, HALF = 128, HTB = HALF * BK * 2, STAGE_BYTES = 8 * HTB, NXCD = 8, WGM = 8;
__host__ __device__ __forceinline__ int lds_byte(int r, int c) { const int st = (r >> 4) * 2 + (c >> 5), rr = r & 15, cc = c & 31, ob = rr * 64 + cc * 2; return st * 1024 + (ob ^ (((ob >> 9) & 1) << 5)); }
__host__ __device__ __forceinline__ void stage_rc(int b, int& R, int& C) { const int st = b / 1024, sb = b % 1024, swz = sb ^ (((sb >> 9) & 1) << 5); R = (st >> 1) * 16 + swz / 64; C = (st & 1) * 32 + (swz % 64) / 2; }
__host__ __device__ __forceinline__ int perm32(int rho) { const int n = rho >> 4, i = rho & 15; return 8 * (i >> 2) + 4 * n + (i & 3); }
__host__ __device__ __forceinline__ int permB(int kind, int R) {
    return kind == 0 ? R : kind == 1 ? ((R & ~31) + perm32(R & 31)) : ((R & ~0x30) | ((R & 0x10) << 1) | ((R & 0x20) >> 1));
}
struct Unit { int pm, pn; };
struct Gemm { const bf16_t* A; const bf16_t* Bt; int M, N, K; };
struct StaticOrder {
    int nM, nN, nwg, G, c;
    __host__ __device__ void init(int M_, int N_, int G_, int c_) { nM = M_ / BM; nN = N_ / BM; nwg = nM * nN; G = G_; c = c_; }
    __host__ __device__ bool next(int i, Unit& u) const {
        const long L = (long)i * G + c; if (L >= nwg) return false;
        int wgid = (int)L; { const int q = nwg / NXCD, r = nwg % NXCD, xcd = wgid % NXCD, off = wgid / NXCD; wgid = (xcd < r ? xcd * (q + 1) : r * (q + 1) + (xcd - r) * q) + off; }
        const int nig = WGM * nN, gid = wgid / nig, fm = gid * WGM, gsz = (nM - fm) < WGM ? (nM - fm) : WGM;
        u.pm = fm + ((wgid % nig) % gsz); u.pn = (wgid % nig) / gsz; return true;
    }
};

template <class Epi, class Sched, bool ALIGN_EPI = true>
__device__ __forceinline__ void gemm_phase(LAS unsigned char* lds, const Gemm g, const Sched& S, const Epi& E) {
    const int tid = threadIdx.x, wid = __builtin_amdgcn_readfirstlane(tid >> 6), lane = tid & 63, wr = wid >> 2, wc = wid & 3, fr = lane & 15, fq = lane >> 4;
    const int K = g.K, nt = K / BK;
    unsigned voffA[2], voffB0[2], voffB1[2];
#pragma unroll
    for (int i = 0; i < 2; ++i) { int R, C; stage_rc(tid * 16 + i * 8192, R, C);
        voffA[i] = (unsigned)(R * K + C) * 2u; voffB0[i] = (unsigned)(permB(Epi::KIND0, R) * K + C) * 2u; voffB1[i] = (unsigned)(permB(Epi::KIND1, R) * K + C) * 2u; }
    const size_t kstep = (size_t)(BK * 2);
    const size_t hstep = (size_t)HALF * K * 2;
    const size_t tstep = 2 * hstep;
    const unsigned ldsw = (unsigned)wid * 1024u;
    const int aoff = lds_byte(wr * 64 + fr, fq * 8), boff = lds_byte(wc * 32 + fr, fq * 8);
#define PG8_SA(b, h) (((b) * 2 + (h)) * HTB)
#define PG8_SB(b, h) ((4 + (b) * 2 + (h)) * HTB)
#define PG8_STAGE2(bufoff, gbase, v0, v1) do { \
        __builtin_amdgcn_global_load_lds((const unsigned*)((const char*)(gbase) + (v0)), (LAS unsigned*)(lds + (bufoff) + ldsw), 16, 0, 0); \
        __builtin_amdgcn_global_load_lds((const unsigned*)((const char*)(gbase) + (v1)), (LAS unsigned*)(lds + (bufoff) + ldsw + 8192), 16, 0, 0); } while (0)
#define PG8_STAGEA(bufoff, gbase) PG8_STAGE2(bufoff, gbase, voffA[0], voffA[1])
#define PG8_LDA(dst, b, h) do { _Pragma("unroll") for (int m = 0; m < 4; ++m) _Pragma("unroll") for (int k = 0; k < 2; ++k) dst[m][k] = *(const LAS bf16x8*)(lds + PG8_SA(b, h) + aoff + m * 2048 + k * 1024); } while (0)
#define PG8_LDB(dst, b, h) do { _Pragma("unroll") for (int n = 0; n < 2; ++n) _Pragma("unroll") for (int k = 0; k < 2; ++k) dst[n][k] = *(const LAS bf16x8*)(lds + PG8_SB(b, h) + boff + n * 2048 + k * 1024); } while (0)
#define PG8_MMA(ai, bj, At, Bt) do { __builtin_amdgcn_s_setprio(1); _Pragma("unroll") for (int m = 0; m < 4; ++m) _Pragma("unroll") for (int n = 0; n < 2; ++n) _Pragma("unroll") for (int k = 0; k < 2; ++k) \
        acc[ai][bj][m][n] = __builtin_amdgcn_mfma_f32_16x16x32_bf16(Bt[n][k], At[m][k], acc[ai][bj][m][n], 0, 0, 0); __builtin_amdgcn_s_setprio(0); } while (0)
#define PG8_WAIT_V(n) asm volatile("s_waitcnt vmcnt(" #n ")" ::: "memory")
#define PG8_WAIT_L(n) asm volatile("s_waitcnt lgkmcnt(" #n ")" ::: "memory")
#define PG8_BAR __builtin_amdgcn_s_barrier()
#define PG8_SCHED __builtin_amdgcn_sched_barrier(0)
    Unit cur, nxt; int ui = 0;
    if (!S.next(0, cur)) return;
    f32x4 acc[2][2][4][2];
#pragma unroll
    for (int a = 0; a < 2; ++a)
#pragma unroll
        for (int b = 0; b < 2; ++b)
#pragma unroll
            for (int m = 0; m < 4; ++m)
#pragma unroll
                for (int n = 0; n < 2; ++n) acc[a][b][m][n] = (f32x4){0.f, 0.f, 0.f, 0.f};
    bf16x8 At[4][2], B0[2][2], B1[2][2];
    const char* cA = (const char*)g.A + (size_t)cur.pm * tstep; const char* cB = (const char*)g.Bt + (size_t)cur.pn * tstep;
    unsigned vc0 = E.alt(cur.pn) ? voffB1[0] : voffB0[0], vc1 = E.alt(cur.pn) ? voffB1[1] : voffB0[1];
    PG8_STAGE2(PG8_SB(0, 0), cB, vc0, vc1); PG8_STAGE2(PG8_SB(0, 1), cB + hstep, vc0, vc1); PG8_STAGEA(PG8_SA(0, 0), cA); PG8_STAGEA(PG8_SA(0, 1), cA + hstep);
    if (wr == 1) PG8_BAR;
    PG8_WAIT_V(2); PG8_BAR;
    PG8_STAGE2(PG8_SB(1, 0), cB + kstep, vc0, vc1); PG8_STAGEA(PG8_SA(1, 0), cA + kstep); PG8_STAGE2(PG8_SB(1, 1), cB + hstep + kstep, vc0, vc1);
    PG8_WAIT_V(6); PG8_BAR;
    for (;;) {
        const bool has_next = S.next(ui + 1, nxt);
        const char* nA = has_next ? (const char*)g.A + (size_t)nxt.pm * tstep : cA; const char* nB = has_next ? (const char*)g.Bt + (size_t)nxt.pn * tstep : cB;
        const bool nalt = has_next ? E.alt(nxt.pn) : E.alt(cur.pn);
        const unsigned vn0 = nalt ? voffB1[0] : voffB0[0], vn1 = nalt ? voffB1[1] : voffB0[1];
        for (int t = 0; t < nt; t += 2) {
            const bool last = (t == nt - 2);
            const char* a1 = cA + (size_t)(t + 1) * kstep;
            const char* a2 = last ? nA : cA + (size_t)(t + 2) * kstep; const char* b2 = last ? nB : cB + (size_t)(t + 2) * kstep;
            const char* a3 = a2 + kstep; const char* b3 = b2 + kstep;
            const unsigned v20 = last ? vn0 : vc0, v21 = last ? vn1 : vc1;
            PG8_LDB(B0, 0, 0); PG8_LDB(B1, 0, 1); PG8_SCHED; PG8_LDA(At, 0, 0); PG8_STAGEA(PG8_SA(1, 1), a1 + hstep);
            PG8_WAIT_V(8); PG8_WAIT_L(0); PG8_BAR; PG8_MMA(0, 0, At, B0); PG8_MMA(0, 1, At, B1); PG8_BAR; PG8_SCHED;
            PG8_LDA(At, 0, 1); PG8_STAGE2(PG8_SB(0, 0), b2, v20, v21); PG8_STAGE2(PG8_SB(0, 1), b2 + hstep, v20, v21); PG8_STAGEA(PG8_SA(0, 0), a2);
            PG8_WAIT_V(8); PG8_WAIT_L(0); PG8_BAR; PG8_MMA(1, 0, At, B0); PG8_MMA(1, 1, At, B1); PG8_BAR; PG8_SCHED;
            PG8_LDB(B0, 1, 0); PG8_LDB(B1, 1, 1); PG8_SCHED; PG8_LDA(At, 1, 0); PG8_STAGEA(PG8_SA(0, 1), a2 + hstep);
            PG8_WAIT_V(8); PG8_WAIT_L(0); PG8_BAR; PG8_MMA(0, 0, At, B0); PG8_MMA(0, 1, At, B1); PG8_BAR; PG8_SCHED;
            PG8_LDA(At, 1, 1); PG8_STAGE2(PG8_SB(1, 0), b3, v20, v21); PG8_STAGE2(PG8_SB(1, 1), b3 + hstep, v20, v21); PG8_STAGEA(PG8_SA(1, 0), a3);
            PG8_WAIT_V(8); PG8_WAIT_L(0); PG8_BAR; PG8_MMA(1, 0, At, B0); PG8_MMA(1, 1, At, B1); PG8_BAR; PG8_SCHED;
        }
        if constexpr (ALIGN_EPI) { if (wr == 0) PG8_BAR; }
        E(acc, cur, wr, wc, fr, fq);
        if (!has_next) break;
#pragma unroll
        for (int a = 0; a < 2; ++a)
#pragma unroll
            for (int b = 0; b < 2; ++b)
#pragma unroll
                for (int m = 0; m < 4; ++m)
#pragma unroll
                    for (int n = 0; n < 2; ++n) acc[a][b][m][n] = (f32x4){0.f, 0.f, 0.f, 0.f};
        cur = nxt; cA = nA; cB = nB; vc0 = vn0; vc1 = vn1; ++ui;
        if constexpr (ALIGN_EPI) { if (wr == 1) PG8_BAR; }
    }
    PG8_WAIT_V(0);
    if constexpr (!ALIGN_EPI) { if (wr == 0) PG8_BAR; }
    PG8_BAR;
#undef PG8_SA
#undef PG8_SB
#undef PG8_STAGE2
#undef PG8_STAGEA
#undef PG8_LDA
#undef PG8_LDB
#undef PG8_MMA
#undef PG8_WAIT_V
#undef PG8_WAIT_L
#undef PG8_BAR
#undef PG8_SCHED
}

struct EpiIn {
    static constexpr int KIND0 = 1, KIND1 = 2;
    bf16_t *U, *V, *ZA, *Q, *Kb, *VB, *ZB; float2* vst; const float2* rope;
    __device__ __forceinline__ bool alt(int pn) const { return pn >= 12 && pn <= 16; }
    __device__ __forceinline__ void operator()(const f32x4 (&acc)[2][2][4][2], const Unit& u, int wr, int wc, int fr, int fq) const {
        const int pn = u.pn; const int row0 = u.pm * BM + wr * 64 + fr;
        if (pn >= 12 && pn <= 16) {
            const int d0 = 16 * (wc & 1) + 4 * fq;
            bf16_t* base; int ld; float sc;
            if (pn < 16) { base = Q + (pn - 12) * 256; ld = 1024; sc = QSCALE; } else { base = Kb; ld = 256; sc = 1.f; }
            base += (wc >> 1) * 64 + d0;
#pragma unroll
            for (int ai = 0; ai < 2; ++ai)
#pragma unroll
                for (int m = 0; m < 4; ++m) {
                    const int row = row0 + ai * HALF + m * 16; const int t = row & (SEQ - 1);
                    const f32x4* tp = (const f32x4*)(rope + t * 32 + d0);
                    const f32x4 c01 = tp[0], c23 = tp[1];
                    const float cs[4] = {c01[0], c01[2], c23[0], c23[2]}, sn[4] = {c01[1], c01[3], c23[1], c23[3]};
                    bf16_t* rowp = base + (size_t)row * ld;
#pragma unroll
                    for (int bj = 0; bj < 2; ++bj) {
                        const f32x4 x1 = acc[ai][bj][m][0], x2 = acc[ai][bj][m][1]; float o1[4], o2[4];
#pragma unroll
                        for (int e = 0; e < 4; ++e) { o1[e] = (x1[e] * cs[e] - x2[e] * sn[e]) * sc; o2[e] = (x2[e] * cs[e] + x1[e] * sn[e]) * sc; }
                        u32x2 w1, w2; w1.x = cvt_pk_bf16(o1[0], o1[1]); w1.y = cvt_pk_bf16(o1[2], o1[3]); w2.x = cvt_pk_bf16(o2[0], o2[1]); w2.y = cvt_pk_bf16(o2[2], o2[3]);
                        *(u32x2*)(rowp + bj * HALF) = w1; *(u32x2*)(rowp + bj * HALF + 32) = w2;
                    }
                }
        } else {
            bf16_t* base; int ld = 1024; bool act = false, stat = false;
            if (pn < 4) base = U + pn * 256; else if (pn < 8) { base = V + (pn - 4) * 256; stat = true; } else if (pn < 12) { base = ZA + (pn - 8) * 256; act = true; }
            else if (pn == 17) { base = VB; ld = 256; } else { base = ZB + (pn - 18) * 256; act = true; }
            base += wc * 32 + 8 * fq;
#pragma unroll
            for (int ai = 0; ai < 2; ++ai)
#pragma unroll
                for (int m = 0; m < 4; ++m) {
                    const int row = row0 + ai * HALF + m * 16; bf16_t* rowp = base + (size_t)row * ld; float s = 0.f, q = 0.f;
#pragma unroll
                    for (int bj = 0; bj < 2; ++bj) {
                        f32x4 v0 = acc[ai][bj][m][0], v1 = acc[ai][bj][m][1];
                        if (act) {
#pragma unroll
                            for (int e = 0; e < 4; ++e) { v0[e] = silu_fast(v0[e]); v1[e] = silu_fast(v1[e]); }
                        }
                        if (stat) {
#pragma unroll
                            for (int e = 0; e < 4; ++e) { s += v0[e] + v1[e]; q += v0[e] * v0[e] + v1[e] * v1[e]; }
                        }
                        u32x4 w; w.x = cvt_pk_bf16(v0[0], v0[1]); w.y = cvt_pk_bf16(v0[2], v0[3]); w.z = cvt_pk_bf16(v1[0], v1[1]); w.w = cvt_pk_bf16(v1[2], v1[3]);
                        *(u32x4*)(rowp + bj * HALF) = w;
                    }
                    if (stat) {
                        s += __shfl_xor(s, 16); s += __shfl_xor(s, 32); q += __shfl_xor(q, 16); q += __shfl_xor(q, 32);
                        if (fq == 0) vst[(size_t)row * 16 + (pn - 4) * 4 + wc] = make_float2(s, q);
                    }
                }
        }
    }
};
struct EpiOut {
    static constexpr int KIND0 = 0, KIND1 = 0;
    const float* x; const float* mod; float* out;
    __device__ __forceinline__ bool alt(int) const { return false; }
    __device__ __forceinline__ void operator()(const f32x4 (&acc)[2][2][4][2], const Unit& u, int wr, int wc, int fr, int fq) const {
        const int row0 = u.pm * BM + wr * 64 + fr, col0 = u.pn * BM + wc * 32 + 4 * fq; const int b = (u.pm * BM) / SEQ;
        const float* gate = mod + (size_t)b * 6144 + 4096 + col0;
        f32x4 gv[2][2];
#pragma unroll
        for (int bj = 0; bj < 2; ++bj)
#pragma unroll
            for (int n = 0; n < 2; ++n) gv[bj][n] = *(const f32x4*)(gate + bj * HALF + n * 16);
#pragma unroll
        for (int ai = 0; ai < 2; ++ai)
#pragma unroll
            for (int m = 0; m < 4; ++m) { const size_t off = (size_t)(row0 + ai * HALF + m * 16) * D_MODEL + col0;
#pragma unroll
                for (int bj = 0; bj < 2; ++bj)
#pragma unroll
                    for (int n = 0; n < 2; ++n) { const f32x4 xv = *(const f32x4*)(x + off + bj * HALF + n * 16); *(f32x4*)(out + off + bj * HALF + n * 16) = xv + gv[bj][n] * acc[ai][bj][m][n]; }
            }
    }
};
}

typedef GAS unsigned gu32;
#define XB_TMO      128
#define XB_XCNT(j)  (256  + 64 * (j))
#define XB_XSUB(j)  (1280 + 64 * (j))
#define XB_XGEN(j)  (2304 + 64 * (j))
#define XB_TOP      3328
#define XB_TOPGEN   3392
#define XCD_BAR_WORDS 3456
#define XB_SPIN_CAP (1u << 18)
__device__ __forceinline__ unsigned xb_ld(unsigned* p)              { return __hip_atomic_load(p, __ATOMIC_RELAXED, __HIP_MEMORY_SCOPE_AGENT); }
__device__ __forceinline__ unsigned xb_add(unsigned* p, unsigned v) { return __hip_atomic_fetch_add(p, v, __ATOMIC_RELAXED, __HIP_MEMORY_SCOPE_AGENT); }
__device__ __forceinline__ unsigned xb_xcc_id() { return (unsigned)__builtin_amdgcn_s_getreg((3 << 11) | 20) & 0xFu; }
#define XB_SPIN(cond, bar) do { unsigned _sp = 0; while (cond) { __builtin_amdgcn_s_sleep(1); \
    if ((++_sp & 255u) == 0u) { if (xb_ld(&(bar)[XB_TMO])) break; if (_sp > XB_SPIN_CAP) { atomicAdd(&(bar)[XB_TMO], 1u); break; } } } } while (0)
struct XcdBarrier { unsigned* bar; unsigned x; volatile LAS unsigned* st; };
__device__ __forceinline__ XcdBarrier xcd_barrier_post(unsigned* bar, volatile LAS unsigned* st) {
    XcdBarrier b; b.bar = bar; b.x = xb_xcc_id(); b.st = st;
    if (threadIdx.x == 0) (void)xb_add(&bar[XB_XCNT(b.x)], 1u);
    return b;
}
__device__ __forceinline__ void xcd_barrier_complete(unsigned* bar, unsigned x, unsigned& nloc, unsigned& nx) {
    const unsigned G = gridDim.x * gridDim.y * gridDim.z;
    unsigned sum, cnt, mine, sp = 0u;
    for (;;) {
        sum = 0u; cnt = 0u; mine = 0u;
#pragma unroll
        for (unsigned j = 0; j < 16; ++j) { const unsigned c = xb_ld(&bar[XB_XCNT(j)]); sum += c; cnt += (c > 0u) ? 1u : 0u; mine = (j == x) ? c : mine; }
        if (sum == G) break;
        __builtin_amdgcn_s_sleep(1);
        if ((++sp & 255u) == 0u) { if (xb_ld(&bar[XB_TMO])) break; if (sp > XB_SPIN_CAP) { atomicAdd(&bar[XB_TMO], 1u); break; } }
    }
    nloc = mine > 0u ? mine : 1u; nx = cnt > 0u ? cnt : 1u;
}
__device__ __forceinline__ void xcd_barrier(const XcdBarrier& b) {
    asm volatile("s_waitcnt vmcnt(0)" ::: "memory");
    __syncthreads();
    if (threadIdx.x == 0) {
        unsigned* bar = b.bar;
        __builtin_amdgcn_s_waitcnt(0);
        unsigned nloc = b.st[0], nx = b.st[1];
        if (nloc == 0u) { xcd_barrier_complete(bar, b.x, nloc, nx); b.st[0] = nloc; b.st[1] = nx; }
        const unsigned old = xb_add(&bar[XB_XSUB(b.x)], 1u);
        const unsigned gen = old / nloc;
        if (old + 1u == (gen + 1u) * nloc) {
            __builtin_amdgcn_fence(__ATOMIC_RELEASE, "agent");
            asm volatile("s_waitcnt vmcnt(0)" ::: "memory");
            const unsigned og = xb_add(&bar[XB_TOP], 1u);
            const unsigned tg = og / nx;
            if (og + 1u == (tg + 1u) * nx) xb_add(&bar[XB_TOPGEN], 1u);
            else XB_SPIN(xb_ld(&bar[XB_TOPGEN]) == tg, bar);
            __builtin_amdgcn_fence(__ATOMIC_ACQUIRE, "agent");
            xb_add(&bar[XB_XGEN(b.x)], 1u);
            asm volatile("s_waitcnt vmcnt(0)" ::: "memory");
        } else {
            XB_SPIN(xb_ld(&bar[XB_XGEN(b.x)]) == gen, bar);
            __builtin_amdgcn_fence(__ATOMIC_ACQUIRE, "agent");
            asm volatile("s_waitcnt vmcnt(0)" ::: "memory");
        }
    }
    __syncthreads();
}

constexpr int RING_BYTES = 131072;
constexpr int MISC_OFF = RING_BYTES + 320;
constexpr int LDS_BYTES = 147456;

struct Args {
    const float *x, *c, *w_ada, *b_ada, *norm_g, *w_in, *ln_g, *ln_b, *w_sp, *b_sp, *sinks, *w_out, *w_adaf, *b_adaf, *gf;
    float* out; unsigned char* ws; int ph_lo, ph_hi;
};
struct Frame { LAS unsigned char* lds; int tid, lane, wave, vcu, G; };

__device__ __forceinline__ float wave_sum(float v) {
#pragma unroll
    for (int o = 1; o < 64; o <<= 1) v += __shfl_xor(v, o);
    return v;
}

__device__ __forceinline__ void p0_transpose_item(const float* W, int K, int N, bf16_t* WT, LAS float* scr, int item, int lane) {
    const int nblk = N / 32, kb = item / nblk, nb = item % nblk, k0 = 64 * kb, n0 = 32 * nb;
#pragma unroll 8
    for (int i = 0; i < 32; ++i) { const int kk = 2 * i + (lane >> 5); scr[kk * 33 + (lane & 31)] = W[(size_t)(k0 + kk) * N + n0 + (lane & 31)]; }
    asm volatile("s_waitcnt lgkmcnt(0)" ::: "memory");
    const int c = lane & 7;
#pragma unroll
    for (int j = 0; j < 4; ++j) { const int n = (lane >> 3) + 8 * j; const LAS float* s = scr + (8 * c) * 33 + n;
        u32x4 o; o.x = pk2(s[0 * 33], s[1 * 33]); o.y = pk2(s[2 * 33], s[3 * 33]); o.z = pk2(s[4 * 33], s[5 * 33]); o.w = pk2(s[6 * 33], s[7 * 33]);
        *(GAS u32x4*)(WT + (size_t)(n0 + n) * K + k0 + 8 * c) = o; }
    asm volatile("s_waitcnt lgkmcnt(0)" ::: "memory");
}
__device__ __forceinline__ void p0_prologue(const Frame& F, const Args& a) {
    unsigned char* ws = a.ws;
    float* mod = (float*)(ws + WS_MOD); float* modf = mod + 4 * 6144;
    LAS f32x4* ca = (LAS f32x4*)F.lds;
    LAS float* red = (LAS float*)(F.lds + 32768);
    for (int i = F.tid; i < 2048; i += NTHREADS) { f32x4 v; v[0] = siluf(a.c[i]); v[1] = siluf(a.c[2048 + i]); v[2] = siluf(a.c[4096 + i]); v[3] = siluf(a.c[6144 + i]); ca[i] = v; }
    __syncthreads();
    for (int item = F.vcu; item < 640; item += F.G) {
        const int n0 = item * 16; const float* W; int N; const float* bias; float* outp; int col0;
        if (n0 < 6144) { W = a.w_ada; N = 6144; bias = a.b_ada; outp = mod; col0 = n0; } else { W = a.w_adaf; N = 4096; bias = a.b_adaf; outp = modf; col0 = n0 - 6144; }
        const int r = F.tid >> 2, c4 = F.tid & 3;
        f32x4 acc[4];
#pragma unroll
        for (int b = 0; b < 4; ++b) acc[b] = (f32x4){0.f, 0.f, 0.f, 0.f};
        const float* wp = W + (size_t)r * N + col0 + 4 * c4;
#pragma unroll 4
        for (int p = 0; p < 16; ++p) { const f32x4 w = *(const f32x4*)(wp + (size_t)p * 128 * N); const f32x4 cv = ca[p * 128 + r];
#pragma unroll
            for (int b = 0; b < 4; ++b) acc[b] += cv[b] * w; }
#pragma unroll
        for (int b = 0; b < 4; ++b)
#pragma unroll
            for (int e = 0; e < 4; ++e) { float v = acc[b][e]; v += __shfl_xor(v, 4); v += __shfl_xor(v, 8); v += __shfl_xor(v, 16); v += __shfl_xor(v, 32); acc[b][e] = v; }
        if (F.lane < 4) {
#pragma unroll
            for (int b = 0; b < 4; ++b)
#pragma unroll
                for (int e = 0; e < 4; ++e) red[(F.wave * 4 + F.lane) * 16 + b * 4 + e] = acc[b][e];
        }
        __syncthreads();
        if (F.tid < 64) { const int b = F.tid >> 4, cc = F.tid & 15, c4b = cc >> 2, e = cc & 3; float s = 0.f;
#pragma unroll
            for (int w = 0; w < 8; ++w) s += red[(w * 4 + c4b) * 16 + b * 4 + e];
            outp[(size_t)b * N + col0 + cc] = s + bias[col0 + cc]; }
        __syncthreads();
    }
    bf16_t* WinT = (bf16_t*)(ws + WS_WIN); bf16_t* WoutT = (bf16_t*)(ws + WS_WOUT);
    LAS float* scr = (LAS float*)(F.lds + 40960 + F.wave * 8704);
    const int gw = F.vcu * NWAVES + F.wave, NGW = F.G * NWAVES;
    constexpr int I_IN = (2048 / 64) * (D_IN / 32), I_OUT = (2048 / 64) * (2048 / 32);
    for (int it = gw; it < I_IN + I_OUT; it += NGW) {
        if (it < I_IN) p0_transpose_item(a.w_in, 2048, D_IN, WinT, scr, it, F.lane);
        else p0_transpose_item(a.w_out, 2048, 2048, WoutT, scr, it - I_IN, F.lane);
    }
    float2* rope = (float2*)(ws + WS_ROPE); bf16_t* Wsb = (bf16_t*)(ws + WS_WS);
    const int gt = F.vcu * NTHREADS + F.tid, NGT = F.G * NTHREADS;
    for (int i = gt; i < SEQ * 32; i += NGT) rope[i] = rope_entry(i / 32, i % 32);
    for (int i = gt; i < 8 * 128 * 128; i += NGT) { const int t = (i / 128) % 128, tp = i % 128; Wsb[i] = tp <= t ? (bf16_t)f2bf(a.w_sp[i]) : (bf16_t)0; }
}

template <bool TO_BF16> __device__ __forceinline__ void rows_norm(const Frame& F, const float* xin, const float* g, const float* shift0, const float* scale0, int bstride, bf16_t* outb, float* outf) {
    const int rows_per_block = M / F.G, rows_per_wave = rows_per_block / NWAVES;
    const int r0 = F.vcu * rows_per_block + F.wave * rows_per_wave; const int b = r0 / SEQ;
    const float* shift = shift0 + (size_t)b * bstride; const float* scale = scale0 + (size_t)b * bstride;
    f32x4 A[8], B[8];
#pragma unroll
    for (int j = 0; j < 8; ++j) { const int c = 4 * F.lane + 256 * j; const f32x4 gg = *(const f32x4*)(g + c), sc = *(const f32x4*)(scale + c); A[j] = gg * (sc + 1.0f); B[j] = *(const f32x4*)(shift + c); }
    for (int i = 0; i < rows_per_wave; ++i) {
        const int row = r0 + i; const GAS f32x4* xr = (const GAS f32x4*)(xin + (size_t)row * D_MODEL) + F.lane;
        f32x4 v[8]; float s = 0.f;
#pragma unroll
        for (int j = 0; j < 8; ++j) { v[j] = xr[64 * j]; s += (v[j][0] * v[j][0] + v[j][1] * v[j][1]) + (v[j][2] * v[j][2] + v[j][3] * v[j][3]); }
        const float rstd = 1.f / sqrtf(wave_sum(s) * (1.f / D_MODEL) + NORM_EPS);
        if constexpr (TO_BF16) {
            GAS u32x2* o8 = (GAS u32x2*)(outb + (size_t)row * D_MODEL) + F.lane;
#pragma unroll
            for (int j = 0; j < 8; ++j) { const f32x4 y = v[j] * rstd * A[j] + B[j]; u32x2 w; w.x = pk2(y[0], y[1]); w.y = pk2(y[2], y[3]); o8[64 * j] = w; }
        } else {
            GAS f32x4* o = (GAS f32x4*)(outf + (size_t)row * D_MODEL) + F.lane;
#pragma unroll
            for (int j = 0; j < 8; ++j) o[64 * j] = v[j] * rstd * A[j] + B[j];
        }
    }
}

constexpr int G_LW = 0, G_LV = 32768, G_ST = 65536;
__device__ __forceinline__ int lv_f(int row) { return (row & 3) | (((row >> 3) & 1) << 2); }
__device__ __forceinline__ s16x4 vtr(const LAS unsigned char* p) { return __builtin_bit_cast(s16x4, __builtin_amdgcn_ds_read_tr16_b64_v4i16((LAS s16x4*)p)); }
__device__ __forceinline__ void p3_gating(const Frame& F, const Args& a) {
    unsigned char* ws = a.ws;
    const bf16_t* U = (const bf16_t*)(ws + WS_U); const bf16_t* V = (const bf16_t*)(ws + WS_V); const bf16_t* ZA = (const bf16_t*)(ws + WS_ZA);
    const float2* vst = (const float2*)(ws + WS_VST); const bf16_t* Wsb = (const bf16_t*)(ws + WS_WS); bf16_t* Y = (bf16_t*)(ws + WS_Y);
    const int g = F.vcu & 7, tid = F.tid, lane = F.lane, w = F.wave;
    LAS unsigned char* LW = F.lds + G_LW; LAS unsigned char* LV = F.lds + G_LV; LAS f32x2* ST = (LAS f32x2*)(F.lds + G_ST);
#pragma unroll
    for (int i = 0; i < 4; ++i) { const int piece = tid + 512 * i, row = piece >> 4, ch = piece & 15;
        const u32x4 v = *(const u32x4*)(Wsb + ((size_t)g * 128 + row) * 128 + ch * 8); *(LAS u32x4*)(LW + row * 256 + ((ch ^ (row & 15)) << 4)) = v; }
    const int ch = tid & 15;
    float lgv[8], lbv[8];
#pragma unroll
    for (int e = 0; e < 8; ++e) { lgv[e] = a.ln_g[g * 128 + ch * 8 + e]; lbv[e] = a.ln_b[g * 128 + ch * 8 + e]; }
    const int tl = lane & 15, kq = lane >> 4;
    float bsv[8];
#pragma unroll
    for (int tb = 0; tb < 8; ++tb) bsv[tb] = a.b_sp[g * 128 + tb * 16 + tl];
    const int nunits = (M / 128) * 8 / F.G;
    for (int ui = 0; ui < nunits; ++ui) {
        const int ck = (F.vcu >> 3) + (F.G >> 3) * ui; const size_t R0 = (size_t)ck * 128;
        u32x2 uf[8], zf[8];
#pragma unroll
        for (int tb = 0; tb < 8; ++tb) { const size_t off = (R0 + tb * 16 + tl) * 1024 + g * 128 + 16 * w + 4 * kq; uf[tb] = *(const u32x2*)(U + off); zf[tb] = *(const u32x2*)(ZA + off); }
        u32x4 vp[4];
#pragma unroll
        for (int i = 0; i < 4; ++i) { const int row = (tid >> 4) + 32 * i; vp[i] = *(const u32x4*)(V + (R0 + row) * 1024 + g * 128 + ch * 8); }
        if (tid < 128) { const float2* p = vst + (R0 + tid) * 16; float s = 0.f, q = 0.f;
#pragma unroll
            for (int j = 0; j < 16; ++j) { const float2 pj = p[j]; s += pj.x; q += pj.y; }
            const float mean = s * (1.f / 1024.f), var = q * (1.f / 1024.f) - mean * mean; ST[tid] = (f32x2){mean, 1.f / sqrtf(var + NORM_EPS)}; }
        __syncthreads();
#pragma unroll
        for (int i = 0; i < 4; ++i) { const int row = (tid >> 4) + 32 * i; const f32x2 st = ST[row]; const u32x4 v = vp[i]; float y[8];
            y[0] = bflo(v.x); y[1] = bfhi(v.x); y[2] = bflo(v.y); y[3] = bfhi(v.y); y[4] = bflo(v.z); y[5] = bfhi(v.z); y[6] = bflo(v.w); y[7] = bfhi(v.w);
#pragma unroll
            for (int e = 0; e < 8; ++e) y[e] = (y[e] - st.x) * st.y * lgv[e] + lbv[e];
            u32x4 o; o.x = pk2(y[0], y[1]); o.y = pk2(y[2], y[3]); o.z = pk2(y[4], y[5]); o.w = pk2(y[6], y[7]);
            *(LAS u32x4*)(LV + row * 256 + ((((ch >> 1) ^ lv_f(row)) << 5) + (ch & 1) * 16)) = o; }
        __syncthreads();
        bf16x8 af[4];
        { const int q = tl >> 2, p = lane & 3;
#pragma unroll
          for (int ks = 0; ks < 4; ++ks) { const int r1 = ks * 32 + 8 * kq + q, r2 = r1 + 4;
              const s16x4 lo = vtr(LV + r1 * 256 + ((w ^ lv_f(r1)) << 5) + 8 * p), hi = vtr(LV + r2 * 256 + ((w ^ lv_f(r2)) << 5) + 8 * p);
              af[ks] = (bf16x8){lo[0], lo[1], lo[2], lo[3], hi[0], hi[1], hi[2], hi[3]}; } }
#pragma unroll
        for (int tb = 0; tb < 8; ++tb) {
            f32x4 acc = (f32x4){0.f, 0.f, 0.f, 0.f}; const int t = tb * 16 + tl;
#pragma unroll
            for (int ks = 0; ks <= (tb >> 1); ++ks) { const bf16x8 bfr = *(const LAS bf16x8*)(LW + t * 256 + (((ks * 4 + kq) ^ (t & 15)) << 4)); acc = __builtin_amdgcn_mfma_f32_16x16x32_bf16(af[ks], bfr, acc, 0, 0, 0); }
            const float u0 = bflo(uf[tb].x), u1 = bfhi(uf[tb].x), u2 = bflo(uf[tb].y), u3 = bfhi(uf[tb].y);
            const float z0 = bflo(zf[tb].x), z1 = bfhi(zf[tb].x), z2 = bflo(zf[tb].y), z3 = bfhi(zf[tb].y);
            const float bsx = bsv[tb];
            u32x2 o; o.x = pk2(u0 * (acc[0] + bsx) * z0, u1 * (acc[1] + bsx) * z1); o.y = pk2(u2 * (acc[2] + bsx) * z2, u3 * (acc[3] + bsx) * z3);
            *(u32x2*)(Y + (R0 + t) * 2048 + g * 128 + 16 * w + 4 * kq) = o;
        }
        __syncthreads();
    }
}

constexpr int A_K = 0, A_V = 32768, A_WS = 65536, A_OST = A_WS + NWAVES * 256, A_END = A_OST + NWAVES * 4096;
__device__ __forceinline__ int crow(int r, int hi) { return (r & 3) + 8 * (r >> 2) + 4 * hi; }
__device__ __forceinline__ void p3_attention(const Frame& F, const Args& a) {
    unsigned char* ws = a.ws;
    const bf16_t* Q = (const bf16_t*)(ws + WS_Q); const bf16_t* Kb = (const bf16_t*)(ws + WS_K); const bf16_t* VB = (const bf16_t*)(ws + WS_VB); const bf16_t* ZB = (const bf16_t*)(ws + WS_ZB);
    bf16_t* Y = (bf16_t*)(ws + WS_Y);
    const int tid = F.tid, lane = F.lane, wid = F.wave, r32 = lane & 31, hi = lane >> 5;
    LAS unsigned char* LK = F.lds + A_K; LAS unsigned char* LVv = F.lds + A_V; LAS float* wsf = (LAS float*)(F.lds + A_WS) + wid * 64; LAS bf16_t* stg = (LAS bf16_t*)(F.lds + A_OST + wid * 4096);
    const int nunits = (BATCH * 32 * 4) / F.G;
    for (int ui = 0; ui < nunits; ++ui) {
        const int u = F.vcu * nunits + ui; const int kvh = u & 3, blk = (u >> 2) & 31, b = u >> 7;
        const long rowq0 = (long)b * SEQ + blk * 128;
        const long rowk0 = rowq0 - 128;
#pragma unroll
        for (int s = 0; s < 4; ++s) {
            u32x4 kv = (u32x4){0u, 0u, 0u, 0u}, vv = (u32x4){0u, 0u, 0u, 0u};
            if (blk > 0 || s >= 2) {
                kv = *(const u32x4*)(Kb + (rowk0 + 64 * s + lane) * 256 + kvh * 64 + wid * 8);
                vv = *(const u32x4*)(VB + (rowk0 + 64 * s + 16 * (wid & 3) + (lane >> 2)) * 256 + kvh * 64 + (wid >> 2) * 32 + (lane & 3) * 8);
            }
            *(LAS u32x4*)(LK + s * 8192 + wid * 1024 + lane * 16) = kv; *(LAS u32x4*)(LVv + s * 8192 + wid * 1024 + lane * 16) = vv;
        }
        __syncthreads();
        const int qs = wid & 3;
#pragma unroll 1
        for (int hh = 0; hh < 2; ++hh) {
            const int head = kvh * 4 + (wid >> 2) * 2 + hh;
            const bf16_t* Qw = Q + (rowq0 + 32 * qs + r32) * 1024 + head * 64 + hi * 8;
            bf16x8 qr[4];
#pragma unroll
            for (int d0 = 0; d0 < 4; ++d0) qr[d0] = *(const bf16x8*)(Qw + d0 * 16);
            f32x16 p[5];
#pragma unroll
            for (int j = 0; j < 5; ++j) {
                const int kt = qs + j; const LAS unsigned char* kp = LK + (kt >> 1) * 8192 + (kt & 1) * 512 + hi * 1024 + r32 * 16;
                f32x16 acc = {};
#pragma unroll
                for (int d0 = 0; d0 < 4; ++d0) { const bf16x8 kf = *(const LAS bf16x8*)(kp + d0 * 2048); acc = __builtin_amdgcn_mfma_f32_32x32x16_bf16(kf, qr[d0], acc, 0, 0, 0); }
                p[j] = acc;
            }
#pragma unroll
            for (int r = 0; r < 16; ++r) { const int cr = crow(r, hi); if (!(cr > r32)) p[0][r] = -INFINITY; if (!(cr <= r32)) p[4][r] = -INFINITY; }
            if (blk == 0) {
#pragma unroll
                for (int j = 0; j < 5; ++j) { if (qs + j < 4) {
#pragma unroll
                    for (int r = 0; r < 16; ++r) p[j][r] = -INFINITY; } }
            }
            const float sink2 = a.sinks[head] * LOG2E;
            float mx = sink2;
#pragma unroll
            for (int j = 0; j < 5; ++j)
#pragma unroll
                for (int r = 0; r < 16; ++r) mx = fmaxf(mx, p[j][r]);
            { auto rr = __builtin_amdgcn_permlane32_swap(__float_as_uint(mx), __float_as_uint(mx), false, false); mx = fmaxf(__uint_as_float(rr[0]), __uint_as_float(rr[1])); }
            float sum = 0.f;
#pragma unroll
            for (int j = 0; j < 5; ++j)
#pragma unroll
                for (int r = 0; r < 16; ++r) { const float e = __builtin_amdgcn_exp2f(p[j][r] - mx); p[j][r] = e; sum += e; }
            { auto rr = __builtin_amdgcn_permlane32_swap(__float_as_uint(sum), __float_as_uint(sum), false, false); sum = __uint_as_float(rr[0]) + __uint_as_float(rr[1]); }
            sum += __builtin_amdgcn_exp2f(sink2 - mx);
            f32x16 o[2]; o[0] = f32x16{}; o[1] = f32x16{};
            const int vb0 = ((lane >> 4) & 1) * 32 + (lane & 3) * 8 + (4 * hi + ((lane & 15) >> 2)) * 64;
#pragma unroll
            for (int j = 0; j < 5; ++j) {
                const int kt = qs + j; const LAS unsigned char* vp = LVv + (kt >> 1) * 8192 + vb0;
#pragma unroll
                for (int s = 0; s < 2; ++s) {
                    const int kg = 2 * (kt & 1) + s;
                    u32x4 pw; pw.x = cvt_pk_bf16(p[j][8 * s + 0], p[j][8 * s + 1]); pw.y = cvt_pk_bf16(p[j][8 * s + 2], p[j][8 * s + 3]); pw.z = cvt_pk_bf16(p[j][8 * s + 4], p[j][8 * s + 5]); pw.w = cvt_pk_bf16(p[j][8 * s + 6], p[j][8 * s + 7]);
                    const bf16x8 pa = __builtin_bit_cast(bf16x8, pw);
#pragma unroll
                    for (int dh = 0; dh < 2; ++dh) {
                        const s16x4 lo = vtr(vp + dh * 4096 + kg * 1024), h2 = vtr(vp + dh * 4096 + kg * 1024 + 512);
                        const bf16x8 vf = (bf16x8){lo[0], lo[1], lo[2], lo[3], h2[0], h2[1], h2[2], h2[3]};
                        o[dh] = __builtin_amdgcn_mfma_f32_32x32x16_bf16(pa, vf, o[dh], 0, 0, 0);
                    }
                }
            }
            if (hi == 0) wsf[r32] = sum;
            asm volatile("s_waitcnt lgkmcnt(0)" ::: "memory");
#pragma unroll
            for (int r = 0; r < 16; ++r) { const int orow = crow(r, hi); const float rl = __builtin_amdgcn_rcpf(wsf[orow]);
                stg[orow * 64 + r32] = (bf16_t)f2bf(o[0][r] * rl); stg[orow * 64 + 32 + r32] = (bf16_t)f2bf(o[1][r] * rl); }
            asm volatile("s_waitcnt lgkmcnt(0)" ::: "memory");
#pragma unroll
            for (int i = 0; i < 4; ++i) { const int row = i * 8 + (lane >> 3), c8 = lane & 7;
                const u32x4 ov = *(const LAS u32x4*)(stg + row * 64 + c8 * 8);
                const u32x4 zv = *(const u32x4*)(ZB + (rowq0 + 32 * qs + row) * 1024 + head * 64 + c8 * 8);
                u32x4 yv; yv.x = pk2(bflo(ov.x) * bflo(zv.x), bfhi(ov.x) * bfhi(zv.x)); yv.y = pk2(bflo(ov.y) * bflo(zv.y), bfhi(ov.y) * bfhi(zv.y));
                yv.z = pk2(bflo(ov.z) * bflo(zv.z), bfhi(ov.z) * bfhi(zv.z)); yv.w = pk2(bflo(ov.w) * bflo(zv.w), bfhi(ov.w) * bfhi(zv.w));
                *(u32x4*)(Y + (rowq0 + 32 * qs + row) * 2048 + 1024 + head * 64 + c8 * 8) = yv; }
            asm volatile("s_waitcnt lgkmcnt(0)" ::: "memory");
        }
        __syncthreads();
    }
}

__global__ void __launch_bounds__(NTHREADS, 2) mk_fwd(Args args) {
    extern __shared__ __attribute__((aligned(16))) unsigned char lds_raw[];
    Frame F; F.lds = (LAS unsigned char*)lds_raw; F.tid = threadIdx.x; F.lane = F.tid & 63; F.wave = __builtin_amdgcn_readfirstlane(F.tid >> 6);
    F.G = gridDim.x; { const int bx = blockIdx.x; F.vcu = (F.G % 8 == 0) ? (bx % 8) * (F.G / 8) + bx / 8 : bx; }
    volatile LAS unsigned* MISC = (volatile LAS unsigned*)(F.lds + MISC_OFF);
    if (F.tid < 32) MISC[F.tid] = 0u;
    __syncthreads();
    unsigned char* ws = args.ws;
    const int lo = args.ph_lo, hi = args.ph_hi;
    XcdBarrier bar; bar.bar = (unsigned*)(ws + WS_CTL) + CW_BAR; bar.x = 0; bar.st = nullptr;
    if (hi - lo > 1) bar = xcd_barrier_post((unsigned*)(ws + WS_CTL) + CW_BAR, MISC + 8);
#define IN(k) (lo <= (k) && (k) < hi)
#define SEAM(k) do { if (IN(k) && IN((k) + 1)) xcd_barrier(bar); } while (0)
    if (IN(0)) { p0_prologue(F, args); }
    SEAM(0);
    if (IN(1)) { const float* mod = (const float*)(ws + WS_MOD); rows_norm<true>(F, args.x, args.norm_g, mod, mod + 2048, 6144, (bf16_t*)(ws + WS_H), nullptr); }
    SEAM(1);
    if (IN(2)) {
        pg8::Gemm g{(const bf16_t*)(ws + WS_H), (const bf16_t*)(ws + WS_WIN), M, D_IN, 2048}; pg8::StaticOrder S; S.init(M, D_IN, F.G, (int)blockIdx.x);
        pg8::EpiIn E{(bf16_t*)(ws + WS_U), (bf16_t*)(ws + WS_V), (bf16_t*)(ws + WS_ZA), (bf16_t*)(ws + WS_Q), (bf16_t*)(ws + WS_K), (bf16_t*)(ws + WS_VB), (bf16_t*)(ws + WS_ZB), (float2*)(ws + WS_VST), (const float2*)(ws + WS_ROPE)};
        pg8::gemm_phase<pg8::EpiIn, pg8::StaticOrder, true>(F.lds, g, S, E);
    }
    SEAM(2);
    if (IN(3)) { p3_gating(F, args); p3_attention(F, args); }
    SEAM(3);
    if (IN(4)) {
        pg8::Gemm g{(const bf16_t*)(ws + WS_Y), (const bf16_t*)(ws + WS_WOUT), M, 2048, 2048}; pg8::StaticOrder S; S.init(M, 2048, F.G, (int)blockIdx.x);
        pg8::EpiOut E{args.x, (const float*)(ws + WS_MOD), args.out};
        pg8::gemm_phase<pg8::EpiOut, pg8::StaticOrder, true>(F.lds, g, S, E);
    }
    SEAM(4);
    if (IN(5)) { const float* modf = (const float*)(ws + WS_MOD) + 4 * 6144; rows_norm<false>(F, args.out, args.gf, modf, modf + 2048, 4096, nullptr, args.out); }
#undef IN
#undef SEAM
}

extern "C" void kernel_launch(void* const* d_in, const int* in_sizes, int n_in, void* d_out, int out_size, void* d_ws, size_t ws_size, hipStream_t stream) {
    static int grid = 0;
    if (grid == 0) {
        if (n_in != 15 || in_sizes[0] != M * D_MODEL || out_size != M * D_MODEL || ws_size < WS_END) { fprintf(stderr, "kernel_launch: unexpected shapes (n_in %d, in0 %d, out %d, ws %zu)\n", n_in, n_in > 0 ? in_sizes[0] : -1, out_size, ws_size); grid = -1; return; }
        int dev = 0, cus = 0, per_cu = 0;
        if (hipGetDevice(&dev) != hipSuccess || hipDeviceGetAttribute(&cus, hipDeviceAttributeMultiprocessorCount, dev) != hipSuccess) { grid = -1; return; }
        if (hipFuncSetAttribute((const void*)mk_fwd, hipFuncAttributeMaxDynamicSharedMemorySize, LDS_BYTES) != hipSuccess) { fprintf(stderr, "kernel_launch: hipFuncSetAttribute failed\n"); grid = -1; return; }
        if (hipOccupancyMaxActiveBlocksPerMultiprocessor(&per_cu, (const void*)mk_fwd, NTHREADS, LDS_BYTES) != hipSuccess || per_cu < 1) { fprintf(stderr, "kernel_launch: occupancy query says %d blocks per CU\n", per_cu); grid = -1; (void)hipGetLastError(); return; }
        grid = cus;
        if (grid != 256) fprintf(stderr, "kernel_launch: note: %d CUs (kernel is tuned for 256)\n", grid);
    }
    if (grid < 0) return;
    Args a{};
    a.x = (const float*)d_in[0]; a.c = (const float*)d_in[1]; a.w_ada = (const float*)d_in[2]; a.b_ada = (const float*)d_in[3]; a.norm_g = (const float*)d_in[4]; a.w_in = (const float*)d_in[5];
    a.ln_g = (const float*)d_in[6]; a.ln_b = (const float*)d_in[7]; a.w_sp = (const float*)d_in[8]; a.b_sp = (const float*)d_in[9]; a.sinks = (const float*)d_in[10]; a.w_out = (const float*)d_in[11];
    a.w_adaf = (const float*)d_in[12]; a.b_adaf = (const float*)d_in[13]; a.gf = (const float*)d_in[14];
    a.out = (float*)d_out; a.ws = (unsigned char*)d_ws;
    (void)hipMemsetAsync((char*)d_ws + WS_CTL, 0, CTL_ZERO_BYTES, stream);
#if MK_ONE_LAUNCH && NAIVE_MASK == 0
    a.ph_lo = 0; a.ph_hi = 6;
    hipLaunchKernelGGL(mk_fwd, dim3(grid), dim3(NTHREADS), LDS_BYTES, stream, a);
#else
    unsigned char* ws = (unsigned char*)d_ws; float* out = (float*)d_out;
    float* mod = (float*)(ws + WS_MOD); float* modf = mod + 4 * 6144; float2* rope = (float2*)(ws + WS_ROPE); bf16_t* Wsb = (bf16_t*)(ws + WS_WS); float2* vst = (float2*)(ws + WS_VST);
    bf16_t* WinT = (bf16_t*)(ws + WS_WIN); bf16_t* WoutT = (bf16_t*)(ws + WS_WOUT); bf16_t* H = (bf16_t*)(ws + WS_H);
    bf16_t* U = (bf16_t*)(ws + WS_U); bf16_t* V = (bf16_t*)(ws + WS_V); bf16_t* ZA = (bf16_t*)(ws + WS_ZA); bf16_t* Q = (bf16_t*)(ws + WS_Q); bf16_t* Kb = (bf16_t*)(ws + WS_K);
    bf16_t* VB = (bf16_t*)(ws + WS_VB); bf16_t* ZB = (bf16_t*)(ws + WS_ZB); bf16_t* Y = (bf16_t*)(ws + WS_Y); float* QKRAW = (float*)(ws + WS_QKRAW);
    (void)mod; (void)modf; (void)rope; (void)Wsb; (void)vst; (void)WinT; (void)WoutT; (void)H; (void)U; (void)V; (void)ZA; (void)Q; (void)Kb; (void)VB; (void)ZB; (void)Y; (void)QKRAW; (void)out;
    for (int ph = 0; ph < 6; ++ph) {
#if NAIVE_MASK != 0
        if ((NAIVE_MASK >> ph) & 1) {
            if (ph == 0) { nv::k_mod<<<160, 64, 0, stream>>>(a.c, a.w_ada, a.b_ada, a.w_adaf, a.b_adaf, mod, modf);
                nv::k_wT<<<(2048 * 5632 + 255) / 256, 256, 0, stream>>>(a.w_in, 2048, 5632, WinT); nv::k_wT<<<(2048 * 2048 + 255) / 256, 256, 0, stream>>>(a.w_out, 2048, 2048, WoutT);
                nv::k_rope<<<(SEQ * 32 + 255) / 256, 256, 0, stream>>>(rope); nv::k_ws<<<(8 * 128 * 128 + 255) / 256, 256, 0, stream>>>(a.w_sp, Wsb); }
            if (ph == 1) nv::k_h<<<M / 4, 256, 0, stream>>>(a.x, a.norm_g, mod, H);
            if (ph == 2) { nv::k_gemm<nv::EpiIn><<<dim3(D_IN / 64, M / 64), 256, 0, stream>>>(H, WinT, M, D_IN, 2048, nv::EpiIn{U, V, ZA, VB, ZB, QKRAW});
                nv::k_ropeqk<<<(int)(((size_t)M * 640 + 255) / 256), 256, 0, stream>>>(QKRAW, rope, Q, Kb); nv::k_vstat<<<M / 256, 256, 0, stream>>>(V, vst); }
            if (ph == 3) { nv::k_gate<<<dim3(M / 128, 8), 128, 0, stream>>>(U, V, ZA, vst, a.ln_g, a.ln_b, Wsb, a.b_sp, Y); nv::k_attn<<<dim3(M, 16), 64, 0, stream>>>(Q, Kb, VB, ZB, a.sinks, Y); }
            if (ph == 4) nv::k_gemm<nv::EpiOut><<<dim3(2048 / 64, M / 64), 256, 0, stream>>>(Y, WoutT, M, 2048, 2048, nv::EpiOut{a.x, mod, out});
            if (ph == 5) nv::k_final<<<M / 4, 256, 0, stream>>>(out, a.gf, modf);
            continue;
        }
#endif
        a.ph_lo = ph; a.ph_hi = ph + 1;
        hipLaunchKernelGGL(mk_fwd, dim3(grid), dim3(NTHREADS), LDS_BYTES, stream, a);
    }
#endif
}
```
